# Optimizing an MI355X kernel written in HIP

```python
import math
import jax, jax.numpy as jnp
from jax import lax
import numpy as np

D_MODEL = 1024
BATCH = 8
SEQ = 8192
DEPTH = 1
DEC_BATCH = 1
DEC_SEQ = 16384
PAST_LEN = 128

MIX_WIDTH = D_MODEL
POOL_WIDTH = 3 * D_MODEL // 8
POOL_WINDOWS = (2, 4, 8, 16)
N_POOL_GROUPS = len(POOL_WINDOWS)
POOL_GROUP = POOL_WIDTH // N_POOL_GROUPS
CONV_WIDTH = 3 * D_MODEL // 8
CONV_KERNEL = 31
ATTN_WIDTH = MIX_WIDTH - POOL_WIDTH - CONV_WIDTH
N_XATTN_HEADS = 4
XATTN_HEAD_DIM = ATTN_WIDTH // N_XATTN_HEADS
XATTN_SCALE = 1.0 / math.sqrt(XATTN_HEAD_DIM)
N_MEM = 256
D_FF = ((8 * D_MODEL // 3 + 255) // 256) * 256
IN_WIDTH = POOL_WIDTH + 2 * CONV_WIDTH + ATTN_WIDTH
LN_EPS = 1e-5
DEEPNORM_ALPHA = (2.0 * DEPTH) ** 0.25
DEEPNORM_BETA = (8.0 * DEPTH) ** -0.25
MACARON_WEIGHT = 0.5

kernel_name = 'hybrid_pool_conv_memory_encoder'


def layer_norm(x, g, b):
    xf = x.astype(jnp.float32)
    mu = jnp.mean(xf, axis=-1, keepdims=True)
    xc = xf - mu
    var = jnp.mean(xc * xc, axis=-1, keepdims=True)
    y = xc * lax.rsqrt(var + LN_EPS)
    return (y * g.astype(jnp.float32) + b.astype(jnp.float32)).astype(x.dtype)


def swiglu(x, w_gate, w_up, w_down):
    return (jax.nn.silu(x @ w_gate) * (x @ w_up)) @ w_down


def pool_mixer(u, pool_w, pool_scale):
    B, S, C = u.shape
    uf = u.astype(jnp.float32)
    cs = jnp.concatenate([jnp.zeros((B, 1, C), jnp.float32), jnp.cumsum(uf, axis=1)], axis=1)
    t = jnp.arange(S)
    outs = []
    for g, w in enumerate(POOL_WINDOWS):
        left = w // 2
        right = w - 1 - left
        lo = jnp.clip(t - left, 0, S)
        hi = jnp.clip(t + right + 1, 0, S)
        c0, c1 = g * POOL_GROUP, (g + 1) * POOL_GROUP
        csg = cs[..., c0:c1]
        win_sum = jnp.take(csg, hi, axis=1) - jnp.take(csg, lo, axis=1)
        win_mean = win_sum / (hi - lo).astype(jnp.float32)[None, :, None]
        outs.append(win_mean - uf[..., c0:c1])
    m = jnp.stack(outs, axis=2).astype(u.dtype)
    y = jnp.einsum('bsgc,gcd->bsgd', m, pool_w).reshape(B, S, POOL_WIDTH)
    return y * pool_scale


def conv_module(a, gate, dw_w, dw_b, ln_g, ln_b):
    h = a * jax.nn.sigmoid(gate)
    pad = CONV_KERNEL // 2
    h = lax.conv_general_dilated(h, dw_w[:, None, :].astype(h.dtype), window_strides=(1,), padding=[(pad, pad)],
                                 dimension_numbers=('NWC', 'WIO', 'NWC'), feature_group_count=CONV_WIDTH) + dw_b
    h = layer_norm(h, ln_g, ln_b)
    return jax.nn.silu(h)


def memory_cross_attention(q, mem, mem_ln_g, mem_ln_b, w_kv):
    B, S, _ = q.shape
    memn = layer_norm(mem, mem_ln_g, mem_ln_b)
    kv = memn @ w_kv
    k = kv[..., :ATTN_WIDTH].reshape(B, -1, N_XATTN_HEADS, XATTN_HEAD_DIM)
    v = kv[..., ATTN_WIDTH:].reshape(B, -1, N_XATTN_HEADS, XATTN_HEAD_DIM)
    qh = q.reshape(B, S, N_XATTN_HEADS, XATTN_HEAD_DIM)
    scores = jnp.einsum('bshd,bmhd->bhsm', qh.astype(jnp.float32), k.astype(jnp.float32)) * XATTN_SCALE
    p = jax.nn.softmax(scores, axis=-1)
    o = jnp.einsum('bhsm,bmhd->bshd', p.astype(v.dtype), v)
    return o.reshape(B, S, ATTN_WIDTH)


def encoder_layer(x, mem,
                  ffn1_w_gate, ffn1_w_up, ffn1_w_down, ln1_g, ln1_b,
                  w_in, pool_w, pool_scale, conv_dw_w, conv_dw_b, conv_ln_g, conv_ln_b,
                  mem_ln_g, mem_ln_b, w_kv, w_out, ln2_g, ln2_b,
                  ffn2_w_gate, ffn2_w_up, ffn2_w_down, ln3_g, ln3_b):
    x = layer_norm(DEEPNORM_ALPHA * x + MACARON_WEIGHT * swiglu(x, ffn1_w_gate, ffn1_w_up, ffn1_w_down), ln1_g, ln1_b)
    z = x @ w_in
    u = z[..., :POOL_WIDTH]
    a = z[..., POOL_WIDTH:POOL_WIDTH + CONV_WIDTH]
    gt = z[..., POOL_WIDTH + CONV_WIDTH:POOL_WIDTH + 2 * CONV_WIDTH]
    q = z[..., POOL_WIDTH + 2 * CONV_WIDTH:]
    y_pool = pool_mixer(u, pool_w, pool_scale)
    y_conv = conv_module(a, gt, conv_dw_w, conv_dw_b, conv_ln_g, conv_ln_b)
    y_attn = memory_cross_attention(q, mem, mem_ln_g, mem_ln_b, w_kv)
    mix = jnp.concatenate([y_pool, y_conv, y_attn], axis=-1) @ w_out
    x = layer_norm(DEEPNORM_ALPHA * x + mix, ln2_g, ln2_b)
    x = layer_norm(DEEPNORM_ALPHA * x + MACARON_WEIGHT * swiglu(x, ffn2_w_gate, ffn2_w_up, ffn2_w_down), ln3_g, ln3_b)
    return x


def _normal(k, shape, scale):
    return scale * jax.random.normal(k, shape, jnp.float32)


def setup_inputs(seed: int = 0) -> dict:
    key = jax.random.key(seed)
    ks = jax.random.split(key, 27)
    L, D = DEPTH, D_MODEL
    return {
        'x_prompt': _normal(ks[0], (BATCH, SEQ, D), 1.0),
        'x_sample': _normal(ks[1], (DEC_BATCH, DEC_SEQ, D), 1.0),
        'mem_prompt': _normal(ks[2], (BATCH, N_MEM, D), 1.0),
        'mem_sample': _normal(ks[3], (DEC_BATCH, N_MEM, D), 1.0),
        'ffn1_w_gate': _normal(ks[4], (L, D, D_FF), D ** -0.5),
        'ffn1_w_up': _normal(ks[5], (L, D, D_FF), D ** -0.5),
        'ffn1_w_down': _normal(ks[6], (L, D_FF, D), DEEPNORM_BETA * D_FF ** -0.5),
        'ln1_g': 1.0 + _normal(ks[7], (L, D), 0.02),
        'ln1_b': _normal(ks[8], (L, D), 0.02),
        'w_in': _normal(ks[9], (L, D, IN_WIDTH), D ** -0.5),
        'pool_w': _normal(ks[10], (L, N_POOL_GROUPS, POOL_GROUP, POOL_GROUP), POOL_GROUP ** -0.5),
        'pool_scale': 1.0 + _normal(ks[11], (L, POOL_WIDTH), 0.02),
        'conv_dw_w': _normal(ks[12], (L, CONV_KERNEL, CONV_WIDTH), CONV_KERNEL ** -0.5),
        'conv_dw_b': _normal(ks[13], (L, CONV_WIDTH), 0.02),
        'conv_ln_g': 1.0 + _normal(ks[14], (L, CONV_WIDTH), 0.02),
        'conv_ln_b': _normal(ks[15], (L, CONV_WIDTH), 0.02),
        'mem_ln_g': 1.0 + _normal(ks[16], (L, D), 0.02),
        'mem_ln_b': _normal(ks[17], (L, D), 0.02),
        'w_kv': _normal(ks[18], (L, D, 2 * ATTN_WIDTH), D ** -0.5),
        'w_out': _normal(ks[19], (L, MIX_WIDTH, D), DEEPNORM_BETA * MIX_WIDTH ** -0.5),
        'ln2_g': 1.0 + _normal(ks[20], (L, D), 0.02),
        'ln2_b': _normal(ks[21], (L, D), 0.02),
        'ffn2_w_gate': _normal(ks[22], (L, D, D_FF), D ** -0.5),
        'ffn2_w_up': _normal(ks[23], (L, D, D_FF), D ** -0.5),
        'ffn2_w_down': _normal(ks[24], (L, D_FF, D), DEEPNORM_BETA * D_FF ** -0.5),
        'ln3_g': 1.0 + _normal(ks[25], (L, D), 0.02),
        'ln3_b': _normal(ks[26], (L, D), 0.02),
    }


def reference(x_prompt, x_sample, mem_prompt, mem_sample,
              ffn1_w_gate, ffn1_w_up, ffn1_w_down, ln1_g, ln1_b,
              w_in, pool_w, pool_scale, conv_dw_w, conv_dw_b, conv_ln_g, conv_ln_b,
              mem_ln_g, mem_ln_b, w_kv, w_out, ln2_g, ln2_b,
              ffn2_w_gate, ffn2_w_up, ffn2_w_down, ln3_g, ln3_b):
    def trunk(x, mem):
        for l in range(DEPTH):
            x = encoder_layer(x, mem,
                              ffn1_w_gate[l], ffn1_w_up[l], ffn1_w_down[l], ln1_g[l], ln1_b[l],
                              w_in[l], pool_w[l], pool_scale[l], conv_dw_w[l], conv_dw_b[l], conv_ln_g[l], conv_ln_b[l],
                              mem_ln_g[l], mem_ln_b[l], w_kv[l], w_out[l], ln2_g[l], ln2_b[l],
                              ffn2_w_gate[l], ffn2_w_up[l], ffn2_w_down[l], ln3_g[l], ln3_b[l])
        return x

    y_prompt = trunk(x_prompt, mem_prompt)
    y_sample = trunk(x_sample, mem_sample)
    return (y_prompt, y_sample)
```

```cpp
#include <hip/hip_runtime.h>
#include <hip/hip_cooperative_groups.h>
#include <cstdio>
#include <cstdint>
namespace cg = cooperative_groups;

namespace pg8 {
#define PG8_LAS __attribute__((address_space(3)))
typedef unsigned short bf16_t;
typedef short bf16x8 __attribute__((ext_vector_type(8)));
typedef float f32x4 __attribute__((ext_vector_type(4)));
typedef float f32x2 __attribute__((ext_vector_type(2)));
typedef unsigned u32x4 __attribute__((ext_vector_type(4)));
typedef unsigned u32x2 __attribute__((ext_vector_type(2)));
constexpr int BM = 256, BK = 64, HALF = 128, HTB = HALF * BK * 2, STAGE_BYTES = 8 * HTB, NXCD = 8, WGM = 8;

__host__ __device__ __forceinline__ int lds_byte(int r, int c) { const int st = (r >> 4) * 2 + (c >> 5), rr = r & 15, cc = c & 31, ob = rr * 64 + cc * 2; return st * 1024 + (ob ^ (((ob >> 9) & 1) << 5)); }
__host__ __device__ __forceinline__ void stage_rc(int b, int& R, int& C) { const int st = b / 1024, sb = b % 1024, swz = sb ^ (((sb >> 9) & 1) << 5); R = (st >> 1) * 16 + swz / 64; C = (st & 1) * 32 + (swz % 64) / 2; }
__host__ __device__ __forceinline__ int perm32(int rho) { const int n = rho >> 4, i = rho & 15; return 8 * (i >> 2) + 4 * n + (i & 3); }

struct Unit { int pm, pn; };
struct Gemm { const bf16_t* A; const bf16_t* Bt; int M, N, K; };

struct StaticOrder {
    int nM, nN, nwg, G, c;
    __host__ __device__ void init(int M, int N, int G_, int c_) { nM = M / BM; nN = N / BM; nwg = nM * nN; G = G_; c = c_; }
    __host__ __device__ bool next(int i, Unit& u) const {
        const long L = (long)i * G + c; if (L >= nwg) return false;
        int wgid = (int)L; { const int q = nwg / NXCD, r = nwg % NXCD, xcd = wgid % NXCD, off = wgid / NXCD; wgid = (xcd < r ? xcd * (q + 1) : r * (q + 1) + (xcd - r) * q) + off; }
        const int nig = WGM * nN, gid = wgid / nig, fm = gid * WGM, gsz = (nM - fm) < WGM ? (nM - fm) : WGM;
        u.pm = fm + ((wgid % nig) % gsz); u.pn = (wgid % nig) / gsz; return true;
    }
};

__device__ __forceinline__ unsigned cvt_pk_bf16(float lo, float hi) { unsigned r; asm volatile("v_cvt_pk_bf16_f32 %0, %1, %2" : "=v"(r) : "v"(lo), "v"(hi)); return r; }
__device__ __forceinline__ float bf_lo(unsigned v) { return __uint_as_float(v << 16); }
__device__ __forceinline__ float bf_hi(unsigned v) { return __uint_as_float(v & 0xffff0000u); }
__device__ __forceinline__ float sigmoid_f(float x) { return __builtin_amdgcn_rcpf(1.0f + __builtin_amdgcn_exp2f(-1.44269504089f * x)); }


struct EpiSwiGLU {
    static constexpr bool PERM = true, AFTER_DRAIN = false;
    bf16_t* O; int ldc;
    __device__ __forceinline__ void operator()(const f32x4 (&acc)[2][2][4][2], const Unit& u, int wr, int wc, int fr, int fq) const {
        const int row0 = u.pm * BM + wr * 64 + fr; const int col0 = u.pn * HALF + wc * 32 + 8 * fq;
#pragma unroll
        for (int ai = 0; ai < 2; ++ai)
#pragma unroll
            for (int m = 0; m < 4; ++m) {
                bf16_t* rowp = O + (size_t)(row0 + ai * HALF + m * 16) * ldc + col0;
                f32x4 h0, h1;
#pragma unroll
                for (int e = 0; e < 4; ++e) {
                    const float g0 = acc[ai][0][m][0][e], g1 = acc[ai][0][m][1][e];
                    h0[e] = g0 * sigmoid_f(g0) * acc[ai][1][m][0][e];
                    h1[e] = g1 * sigmoid_f(g1) * acc[ai][1][m][1][e];
                }
                u32x4 w; w.x = cvt_pk_bf16(h0[0], h0[1]); w.y = cvt_pk_bf16(h0[2], h0[3]); w.z = cvt_pk_bf16(h1[0], h1[1]); w.w = cvt_pk_bf16(h1[2], h1[3]);
                *(u32x4*)rowp = w;
            }
    }
};

struct EpiStore {
    static constexpr bool PERM = true, AFTER_DRAIN = false;
    bf16_t* O; bf16_t* O2; int ldc; int ncols; int mode;
    __device__ __forceinline__ void operator()(const f32x4 (&acc)[2][2][4][2], const Unit& u, int wr, int wc, int fr, int fq) const {
        const int row0 = u.pm * BM + wr * 64 + fr; const int colt = u.pn * BM; const int col0 = colt + wc * 32 + 8 * fq;
#pragma unroll
        for (int ai = 0; ai < 2; ++ai)
#pragma unroll
            for (int m = 0; m < 4; ++m) {
                const int row = row0 + ai * HALF + m * 16;
#pragma unroll
                for (int bj = 0; bj < 2; ++bj) {
                    const f32x4 v0 = acc[ai][bj][m][0], v1 = acc[ai][bj][m][1];
                    if (mode == 0) {
                        if (colt + bj * HALF < ncols) {
                            u32x4 w; w.x = cvt_pk_bf16(v0[0], v0[1]); w.y = cvt_pk_bf16(v0[2], v0[3]); w.z = cvt_pk_bf16(v1[0], v1[1]); w.w = cvt_pk_bf16(v1[2], v1[3]);
                            *(u32x4*)(O + (size_t)row * ldc + col0 + bj * HALF) = w;
                        }
                    } else {
                        if (u.pn == 0) {
                            u32x4 w; w.x = cvt_pk_bf16(v0[0], v0[1]); w.y = cvt_pk_bf16(v0[2], v0[3]); w.z = cvt_pk_bf16(v1[0], v1[1]); w.w = cvt_pk_bf16(v1[2], v1[3]);
                            *(u32x4*)(O + (size_t)row * 256 + col0 + bj * HALF) = w;
                        } else {
                            const int c = wc * 32 + 8 * fq + bj * HALF;
                            bf16_t* vp = O2 + ((size_t)((row >> 8) * 256 + c)) * 256 + (row & 255);
#pragma unroll
                            for (int e = 0; e < 4; ++e) { vp[(size_t)e * 256] = (bf16_t)(cvt_pk_bf16(v0[e], 0.f) & 0xffffu); vp[(size_t)(4 + e) * 256] = (bf16_t)(cvt_pk_bf16(v1[e], 0.f) & 0xffffu); }
                        }
                    }
                }
            }
    }
};

struct EpiRes {
    static constexpr bool PERM = false, AFTER_DRAIN = false;
    float* out; const float* r32a; const float* r32b; const bf16_t* r16; float alpha, scale;
    __device__ __forceinline__ void operator()(const f32x4 (&acc)[2][2][4][2], const Unit& u, int wr, int wc, int fr, int fq) const {
        const int row0 = u.pm * BM + wr * 64 + fr; const int col0 = u.pn * BM + wc * 32 + 4 * fq;
        const float* rbase = (u.pm * BM < 65536) ? r32a : (r32b - (size_t)65536 * 1024);
#pragma unroll
        for (int ai = 0; ai < 2; ++ai)
#pragma unroll
            for (int m = 0; m < 4; ++m) {
                const size_t off = (size_t)(row0 + ai * HALF + m * 16) * 1024 + col0;
#pragma unroll
                for (int bj = 0; bj < 2; ++bj)
#pragma unroll
                    for (int n = 0; n < 2; ++n) {
                        f32x4 r;
                        if (r16) { const u32x2 t = *(const u32x2*)(r16 + off + bj * HALF + n * 16); r = (f32x4){bf_lo(t.x), bf_hi(t.x), bf_lo(t.y), bf_hi(t.y)}; }
                        else r = *(const f32x4*)(rbase + off + bj * HALF + n * 16);
                        *(f32x4*)(out + off + bj * HALF + n * 16) = r * alpha + acc[ai][bj][m][n] * scale;
                    }
            }
    }
};

template <class Epi, class Sched, bool ALIGN_EPI = false, bool SP2 = false>
__device__ __forceinline__ void gemm_phase(PG8_LAS unsigned char* lds, const Gemm g, const Sched& S, const Epi& E) {
    const int tid = threadIdx.x, wid = __builtin_amdgcn_readfirstlane(tid >> 6), lane = tid & 63, wr = wid >> 2, wc = wid & 3, fr = lane & 15, fq = lane >> 4;
    const int K = g.K, nt = K / BK;
    unsigned voffA[2], voffB[2];
#pragma unroll
    for (int i = 0; i < 2; ++i) { int R, C; stage_rc(tid * 16 + i * 8192, R, C); const int Rb = Epi::PERM ? ((R & ~31) + perm32(R & 31)) : R;
        voffA[i] = (unsigned)(R * K + C) * 2u; voffB[i] = (unsigned)(Rb * K + C) * 2u; }
    const size_t kstep = (size_t)(BK * 2);
    const size_t hstep = (size_t)HALF * K * 2;
    const size_t tstep = 2 * hstep;
    const unsigned ldsw = (unsigned)wid * 1024u;
    const int aoff = lds_byte(wr * 64 + fr, fq * 8), boff = lds_byte(wc * 32 + fr, fq * 8);
#define PG8_SA(b, h) (((b) * 2 + (h)) * HTB)
#define PG8_SB(b, h) ((4 + (b) * 2 + (h)) * HTB)
#define PG8_STAGE(bufoff, gbase, voff) do { _Pragma("unroll") for (int _i = 0; _i < 2; ++_i) \
        __builtin_amdgcn_global_load_lds((const unsigned*)((const char*)(gbase) + (voff)[_i]), (PG8_LAS unsigned*)(lds + (bufoff) + ldsw + _i * 8192), 16, 0, 0); } while (0)
#define PG8_LDA(dst, b, h) do { _Pragma("unroll") for (int m = 0; m < 4; ++m) _Pragma("unroll") for (int k = 0; k < 2; ++k) dst[m][k] = *(const PG8_LAS bf16x8*)(lds + PG8_SA(b, h) + aoff + m * 2048 + k * 1024); } while (0)
#define PG8_LDB(dst, b, h) do { _Pragma("unroll") for (int n = 0; n < 2; ++n) _Pragma("unroll") for (int k = 0; k < 2; ++k) dst[n][k] = *(const PG8_LAS bf16x8*)(lds + PG8_SB(b, h) + boff + n * 2048 + k * 1024); } while (0)
#define PG8_MMA(ai, bj, At, Bt) do { __builtin_amdgcn_s_setprio(1); _Pragma("unroll") for (int m = 0; m < 4; ++m) _Pragma("unroll") for (int n = 0; n < 2; ++n) _Pragma("unroll") for (int k = 0; k < 2; ++k) \
        acc[ai][bj][m][n] = __builtin_amdgcn_mfma_f32_16x16x32_bf16(Bt[n][k], At[m][k], acc[ai][bj][m][n], 0, 0, 0); __builtin_amdgcn_s_setprio(0); } while (0)
#define PG8_WAIT_V(n) asm volatile("s_waitcnt vmcnt(" #n ")" ::: "memory")
#define PG8_WAIT_L(n) asm volatile("s_waitcnt lgkmcnt(" #n ")" ::: "memory")
#define PG8_BAR __builtin_amdgcn_s_barrier()
#define PG8_SCHED __builtin_amdgcn_sched_barrier(0)
    Unit cur, nxt; int ui = 0;
    if (!S.next(0, cur)) return;
    f32x4 acc[2][2][4][2];
#pragma unroll
    for (int a = 0; a < 2; ++a)
#pragma unroll
        for (int b = 0; b < 2; ++b)
#pragma unroll
            for (int m = 0; m < 4; ++m)
#pragma unroll
                for (int n = 0; n < 2; ++n) acc[a][b][m][n] = (f32x4){0.f, 0.f, 0.f, 0.f};
    bf16x8 At[4][2], B0[2][2], B1[2][2];
    const char* cA = (const char*)g.A + (size_t)cur.pm * tstep; const char* cB = (const char*)g.Bt + (size_t)cur.pn * tstep;
    if constexpr (SP2) {
        PG8_STAGE(PG8_SB(0, 0), cB, voffB); PG8_STAGE(PG8_SB(0, 1), cB + hstep, voffB); PG8_STAGE(PG8_SA(0, 0), cA, voffA); PG8_STAGE(PG8_SA(0, 1), cA + hstep, voffA);
        if (wr == 1) PG8_BAR;
        PG8_WAIT_V(2); PG8_BAR;
        PG8_STAGE(PG8_SB(1, 0), cB + kstep, voffB); PG8_STAGE(PG8_SA(1, 0), cA + kstep, voffA); PG8_STAGE(PG8_SB(1, 1), cB + hstep + kstep, voffB);
        PG8_WAIT_V(6); PG8_BAR;
    } else {
        PG8_STAGE(PG8_SB(0, 0), cB, voffB); PG8_STAGE(PG8_SA(0, 0), cA, voffA); PG8_STAGE(PG8_SB(0, 1), cB + hstep, voffB); PG8_STAGE(PG8_SA(0, 1), cA + hstep, voffA);
        if (wr == 1) PG8_BAR;
        PG8_WAIT_V(4); PG8_BAR;
        PG8_STAGE(PG8_SB(1, 0), cB + kstep, voffB); PG8_STAGE(PG8_SA(1, 0), cA + kstep, voffA); PG8_STAGE(PG8_SB(1, 1), cB + hstep + kstep, voffB);
        PG8_WAIT_V(6); PG8_BAR;
    }
    for (;;) {
        const bool has_next = S.next(ui + 1, nxt);
        const char* nA = has_next ? (const char*)g.A + (size_t)nxt.pm * tstep : cA; const char* nB = has_next ? (const char*)g.Bt + (size_t)nxt.pn * tstep : cB;
        for (int t = 0; t < nt; t += 2) {
            const bool last = (t == nt - 2);
            const char* a1 = cA + (size_t)(t + 1) * kstep;
            const char* a2 = last ? nA : cA + (size_t)(t + 2) * kstep; const char* b2 = last ? nB : cB + (size_t)(t + 2) * kstep;
            const char* a3 = a2 + kstep; const char* b3 = b2 + kstep;
            if constexpr (SP2) {
            PG8_LDB(B0, 0, 0); PG8_LDB(B1, 0, 1); PG8_SCHED; PG8_LDA(At, 0, 0); PG8_STAGE(PG8_SA(1, 1), a1 + hstep, voffA);
            PG8_WAIT_V(8); PG8_WAIT_L(0); PG8_BAR; PG8_MMA(0, 0, At, B0); PG8_MMA(0, 1, At, B1); PG8_BAR; PG8_SCHED;
            PG8_LDA(At, 0, 1); PG8_STAGE(PG8_SB(0, 0), b2, voffB); PG8_STAGE(PG8_SB(0, 1), b2 + hstep, voffB); PG8_STAGE(PG8_SA(0, 0), a2, voffA);
            PG8_WAIT_V(8); PG8_WAIT_L(0); PG8_BAR; PG8_MMA(1, 0, At, B0); PG8_MMA(1, 1, At, B1); PG8_BAR; PG8_SCHED;
            PG8_LDB(B0, 1, 0); PG8_LDB(B1, 1, 1); PG8_SCHED; PG8_LDA(At, 1, 0); PG8_STAGE(PG8_SA(0, 1), a2 + hstep, voffA);
            PG8_WAIT_V(8); PG8_WAIT_L(0); PG8_BAR; PG8_MMA(0, 0, At, B0); PG8_MMA(0, 1, At, B1); PG8_BAR; PG8_SCHED;
            PG8_LDA(At, 1, 1); PG8_STAGE(PG8_SB(1, 0), b3, voffB); PG8_STAGE(PG8_SB(1, 1), b3 + hstep, voffB); PG8_STAGE(PG8_SA(1, 0), a3, voffA);
            PG8_WAIT_V(8); PG8_WAIT_L(0); PG8_BAR; PG8_MMA(1, 0, At, B0); PG8_MMA(1, 1, At, B1); PG8_BAR; PG8_SCHED;
            } else {
            PG8_LDB(B0, 0, 0); PG8_SCHED; PG8_LDA(At, 0, 0); PG8_STAGE(PG8_SA(1, 1), a1 + hstep, voffA);
            PG8_WAIT_L(8); PG8_BAR; PG8_WAIT_L(0); PG8_MMA(0, 0, At, B0); PG8_BAR; PG8_SCHED;
            PG8_LDB(B1, 0, 1); PG8_STAGE(PG8_SB(0, 0), b2, voffB);
            PG8_BAR; PG8_WAIT_L(0); PG8_MMA(0, 1, At, B1); PG8_BAR;
            PG8_LDA(At, 0, 1); PG8_STAGE(PG8_SA(0, 0), a2, voffA);
            PG8_BAR; PG8_WAIT_L(0); PG8_MMA(1, 0, At, B0); PG8_BAR; PG8_SCHED;
            PG8_STAGE(PG8_SB(0, 1), b2 + hstep, voffB);
            PG8_WAIT_V(6); PG8_BAR; PG8_MMA(1, 1, At, B1); PG8_BAR;
            PG8_LDB(B0, 1, 0); PG8_SCHED; PG8_LDA(At, 1, 0); PG8_STAGE(PG8_SA(0, 1), a2 + hstep, voffA);
            PG8_WAIT_L(8); PG8_BAR; PG8_WAIT_L(0); PG8_MMA(0, 0, At, B0); PG8_BAR; PG8_SCHED;
            PG8_LDB(B1, 1, 1); PG8_STAGE(PG8_SB(1, 0), b3, voffB);
            PG8_BAR; PG8_WAIT_L(0); PG8_MMA(0, 1, At, B1); PG8_BAR;
            PG8_LDA(At, 1, 1); PG8_STAGE(PG8_SA(1, 0), a3, voffA);
            PG8_BAR; PG8_WAIT_L(0); PG8_MMA(1, 0, At, B0); PG8_BAR; PG8_SCHED;
            PG8_STAGE(PG8_SB(1, 1), b3 + hstep, voffB);
            PG8_WAIT_V(6); PG8_BAR; PG8_MMA(1, 1, At, B1); PG8_BAR;
            }
        }
        if constexpr (ALIGN_EPI) { if (wr == 0) PG8_BAR; }
        if constexpr (!Epi::AFTER_DRAIN) { E(acc, cur, wr, wc, fr, fq); }
        if (!has_next) break;
#pragma unroll
        for (int a = 0; a < 2; ++a)
#pragma unroll
            for (int b = 0; b < 2; ++b)
#pragma unroll
                for (int m = 0; m < 4; ++m)
#pragma unroll
                    for (int n = 0; n < 2; ++n) acc[a][b][m][n] = (f32x4){0.f, 0.f, 0.f, 0.f};
        cur = nxt; cA = nA; cB = nB; ++ui;
        if constexpr (ALIGN_EPI) { if (wr == 1) PG8_BAR; }
    }
    PG8_WAIT_V(0);
    if constexpr (!ALIGN_EPI) { if (wr == 0) PG8_BAR; }
    PG8_BAR;
#undef PG8_SA
#undef PG8_SB
#undef PG8_STAGE
#undef PG8_LDA
#undef PG8_LDB
#undef PG8_MMA
#undef PG8_WAIT_V
#undef PG8_WAIT_L
#undef PG8_BAR
#undef PG8_SCHED
}
}

using pg8::bf16_t; using pg8::bf16x8; using pg8::f32x4; using pg8::f32x2; using pg8::u32x4; using pg8::u32x2;
using pg8::cvt_pk_bf16; using pg8::bf_lo; using pg8::bf_hi; using pg8::sigmoid_f;
#define LAS __attribute__((address_space(3)))

constexpr int NWAVES = 8, NTHREADS = 512;
constexpr int D = 1024, TP = 65536, TS = 16384, T = TP + TS, SEQP = 8192;
constexpr int DFF = 2816, NGU = 2 * DFF, NIN = 1408, NINP = 1536, NMEM = 256, MEMROWS = 9 * NMEM;
constexpr int POOLW = 384, CONVW = 384, ATTW = 256;
constexpr float LN_EPS = 1e-5f, ALPHA = 1.189207115002721f;

constexpr size_t MiB = 1u << 20;
constexpr size_t WS_WGU1 = 1 * MiB, WS_WD1 = 12 * MiB, WS_WGU2 = 18 * MiB, WS_WD2 = 29 * MiB, WS_WIN = 35 * MiB, WS_WKV = 38 * MiB, WS_WOUT = 39 * MiB, WS_PW = 41 * MiB;
constexpr size_t WS_MEMN = 42 * MiB, WS_K = 47 * MiB, WS_VT = 49 * MiB, WS_XB = 52 * MiB, WS_H = 212 * MiB, WS_Z = WS_H, WS_CAT = WS_H + 220 * MiB, WS_END = 652 * MiB;
static_assert(WS_WGU1 + (size_t)NGU * D * 2 <= WS_WD1 && WS_WD1 + (size_t)D * DFF * 2 <= WS_WGU2 && WS_WGU2 + (size_t)NGU * D * 2 <= WS_WD2 && WS_WD2 + (size_t)D * DFF * 2 <= WS_WIN, "ws map 1");
static_assert(WS_WIN + (size_t)NINP * D * 2 <= WS_WKV && WS_WKV + (size_t)512 * D * 2 <= WS_WOUT && WS_WOUT + (size_t)D * D * 2 <= WS_PW && WS_PW + 4 * 96 * 96 * 2 <= WS_MEMN, "ws map 2");
static_assert(WS_MEMN + (size_t)MEMROWS * D * 2 <= WS_K && WS_K + (size_t)MEMROWS * 256 * 2 <= WS_VT && WS_VT + (size_t)MEMROWS * 256 * 2 <= WS_XB && WS_XB + (size_t)T * D * 2 <= WS_H, "ws map 3");
static_assert(WS_Z + (size_t)T * NIN * 2 <= WS_CAT && WS_CAT + (size_t)T * D * 2 <= WS_H + (size_t)T * DFF * 2 && WS_H + (size_t)T * DFF * 2 <= WS_END, "ws map 4");

constexpr int LDS_BYTES = 136 * 1024;
constexpr int UL_STRIDE = 784, UL_ROWS = 80, HL_STRIDE = 768, HL_ROWS = 94, UL_OFF = 0, HL_OFF = UL_ROWS * UL_STRIDE, CL_OFF = 0;
static_assert(HL_OFF % 16 == 0 && HL_OFF + HL_ROWS * HL_STRIDE <= LDS_BYTES && 32 * 384 * 4 <= HL_OFF && pg8::STAGE_BYTES <= LDS_BYTES, "LDS map");

struct Args { const float* in[27]; float* out; unsigned char* ws; int ph_lo, ph_hi; };

__device__ __forceinline__ float wave_sum(float v) {
#pragma unroll
    for (int o = 1; o < 64; o <<= 1) v += __shfl_xor(v, o);
    return v;
}

__device__ __forceinline__ void p0_transpose_item(const float* W, int K, int N, bf16_t* WT, int mode, LAS float* scr, int item, int lane) {
    const int nblk = N / 32, kb = item / nblk, nb = item % nblk, k0 = 64 * kb, n0 = 32 * nb;
    int rbase = n0; if (mode) rbase = 256 * (n0 >> 7) + (n0 & 127) + (mode == 2 ? 128 : 0);
#pragma unroll 8
    for (int i = 0; i < 32; ++i) { const int kk = 2 * i + (lane >> 5); scr[kk * 33 + (lane & 31)] = W[(size_t)(k0 + kk) * N + n0 + (lane & 31)]; }
    asm volatile("s_waitcnt lgkmcnt(0)" ::: "memory");
    const int c = lane & 7;
#pragma unroll
    for (int j = 0; j < 4; ++j) { const int n = (lane >> 3) + 8 * j; const LAS float* s = scr + (8 * c) * 33 + n;
        u32x4 o; o.x = cvt_pk_bf16(s[0 * 33], s[1 * 33]); o.y = cvt_pk_bf16(s[2 * 33], s[3 * 33]); o.z = cvt_pk_bf16(s[4 * 33], s[5 * 33]); o.w = cvt_pk_bf16(s[6 * 33], s[7 * 33]);
        *(u32x4*)(WT + (size_t)(rbase + n) * K + k0 + 8 * c) = o; }
    asm volatile("s_waitcnt lgkmcnt(0)" ::: "memory");
}

template <bool OUT16>
__device__ __forceinline__ void ln_row(const float* xrow, void* orow, const float* g, const float* b, int lane) {
    const f32x4* xr = (const f32x4*)xrow + lane;
    f32x4 v[4]; float s = 0.f;
#pragma unroll
    for (int j = 0; j < 4; ++j) { v[j] = xr[64 * j]; s += (v[j].x + v[j].y) + (v[j].z + v[j].w); }
    const float mean = wave_sum(s) * (1.f / D); float s2 = 0.f;
#pragma unroll
    for (int j = 0; j < 4; ++j) { v[j] = v[j] - mean; s2 += (v[j].x * v[j].x + v[j].y * v[j].y) + (v[j].z * v[j].z + v[j].w * v[j].w); }
    const float rstd = 1.f / sqrtf(wave_sum(s2) * (1.f / D) + LN_EPS);
#pragma unroll
    for (int j = 0; j < 4; ++j) {
        const f32x4 gg = ((const f32x4*)g)[lane + 64 * j], bb = ((const f32x4*)b)[lane + 64 * j];
        const f32x4 y = v[j] * rstd * gg + bb;
        if (OUT16) { u32x2 w; w.x = cvt_pk_bf16(y.x, y.y); w.y = cvt_pk_bf16(y.z, y.w); ((u32x2*)orow)[lane + 64 * j] = w; }
        else ((f32x4*)orow)[lane + 64 * j] = y;
    }
}

template <int G>
__device__ __forceinline__ void pool_job(const LAS unsigned char* uL, int mt, int t0, int seg_lo, int seg_hi, const bf16_t* PW, const float* pscale, bf16_t* CAT, int fr, int fq) {
    constexpr int W = 2 << G, LEFT = W / 2, RIGHT = W - 1 - LEFT;
    const int tl = mt * 16 + fr, t = t0 + tl;
    const int lo = max(t - LEFT, seg_lo), hi = min(t + RIGHT + 1, seg_hi);
    const float inv = 1.0f / (float)(hi - lo);
    bf16x8 bfrag[3];
#pragma unroll
    for (int ks = 0; ks < 3; ++ks) {
        const int chb = (G * 96 + ks * 32 + fq * 8) * 2;
        float s[8];
#pragma unroll
        for (int e = 0; e < 8; ++e) s[e] = 0.f;
#pragma unroll
        for (int i = 0; i < W; ++i) {
            const u32x4 v = *(const LAS u32x4*)(uL + (tl + 8 - LEFT + i) * UL_STRIDE + chb);
#pragma unroll
            for (int e = 0; e < 4; ++e) { s[2 * e] += bf_lo(v[e]); s[2 * e + 1] += bf_hi(v[e]); }
            if ((i & 3) == 3) __builtin_amdgcn_sched_barrier(0);
        }
        const u32x4 c = *(const LAS u32x4*)(uL + (tl + 8) * UL_STRIDE + chb);
        u32x4 p;
#pragma unroll
        for (int e = 0; e < 4; ++e) p[e] = cvt_pk_bf16(s[2 * e] * inv - bf_lo(c[e]), s[2 * e + 1] * inv - bf_hi(c[e]));
        bfrag[ks] = __builtin_bit_cast(bf16x8, p);
        __builtin_amdgcn_sched_barrier(0);
    }
#pragma unroll
    for (int nt = 0; nt < 6; ++nt) {
        f32x4 acc = (f32x4){0.f, 0.f, 0.f, 0.f};
#pragma unroll
        for (int ks = 0; ks < 3; ++ks) {
            const bf16x8 af = *(const bf16x8*)(PW + (size_t)(G * 96 + nt * 16 + fr) * 96 + ks * 32 + fq * 8);
            acc = __builtin_amdgcn_mfma_f32_16x16x32_bf16(af, bfrag[ks], acc, 0, 0, 0);
        }
        const f32x4 sc = *(const f32x4*)(pscale + G * 96 + nt * 16 + fq * 4);
        acc = acc * sc;
        u32x2 w; w.x = cvt_pk_bf16(acc[0], acc[1]); w.y = cvt_pk_bf16(acc[2], acc[3]);
        *(u32x2*)(CAT + (size_t)(t0 + mt * 16 + fr) * 1024 + G * 96 + nt * 16 + fq * 4) = w;
    }
}

__device__ __forceinline__ void attn_job(int t0, int mb, int wid, int fr, int fq, const bf16_t* Z, const bf16_t* KM, const bf16_t* VT, bf16_t* CAT) {
    const int h = wid & 3, half = wid >> 2;
    const bf16_t* Kb = KM + (size_t)(mb * 256) * 256 + h * 64;
    const bf16_t* Vb = VT + (size_t)(mb * 256 + h * 64) * 256;
    bf16x8 qf[2][2];
#pragma unroll
    for (int n2 = 0; n2 < 2; ++n2)
#pragma unroll
        for (int ks = 0; ks < 2; ++ks)
            qf[n2][ks] = *(const bf16x8*)(Z + (size_t)(t0 + half * 32 + n2 * 16 + fr) * NIN + 1152 + h * 64 + ks * 32 + fq * 8);
    f32x4 st[2][16];
#pragma unroll
    for (int mtile = 0; mtile < 16; ++mtile) {
        const bf16_t* kp = Kb + (size_t)(mtile * 16 + fr) * 256 + fq * 8;
        const bf16x8 k0 = *(const bf16x8*)kp, k1 = *(const bf16x8*)(kp + 32);
#pragma unroll
        for (int n2 = 0; n2 < 2; ++n2) {
            f32x4 a = (f32x4){0.f, 0.f, 0.f, 0.f};
            a = __builtin_amdgcn_mfma_f32_16x16x32_bf16(k0, qf[n2][0], a, 0, 0, 0);
            a = __builtin_amdgcn_mfma_f32_16x16x32_bf16(k1, qf[n2][1], a, 0, 0, 0);
            st[n2][mtile] = a;
        }
    }
    float inv[2];
#pragma unroll
    for (int n2 = 0; n2 < 2; ++n2) {
        float mx = -3.0e38f;
#pragma unroll
        for (int mtile = 0; mtile < 16; ++mtile)
#pragma unroll
            for (int e = 0; e < 4; ++e) mx = fmaxf(mx, st[n2][mtile][e]);
        mx = fmaxf(mx, __shfl_xor(mx, 16)); mx = fmaxf(mx, __shfl_xor(mx, 32));
        float sum = 0.f;
        const float sc = 0.125f * 1.44269504089f;
#pragma unroll
        for (int mtile = 0; mtile < 16; ++mtile)
#pragma unroll
            for (int e = 0; e < 4; ++e) { const float p = __builtin_amdgcn_exp2f((st[n2][mtile][e] - mx) * sc); st[n2][mtile][e] = p; sum += p; }
        sum += __shfl_xor(sum, 16); sum += __shfl_xor(sum, 32);
        inv[n2] = 1.0f / sum;
    }
    f32x4 o[2][4];
#pragma unroll
    for (int n2 = 0; n2 < 2; ++n2)
#pragma unroll
        for (int dt = 0; dt < 4; ++dt) o[n2][dt] = (f32x4){0.f, 0.f, 0.f, 0.f};
#pragma unroll
    for (int c = 0; c < 8; ++c) {
        bf16x8 pf[2];
#pragma unroll
        for (int n2 = 0; n2 < 2; ++n2) {
            u32x4 p; p.x = cvt_pk_bf16(st[n2][2 * c][0], st[n2][2 * c][1]); p.y = cvt_pk_bf16(st[n2][2 * c][2], st[n2][2 * c][3]);
            p.z = cvt_pk_bf16(st[n2][2 * c + 1][0], st[n2][2 * c + 1][1]); p.w = cvt_pk_bf16(st[n2][2 * c + 1][2], st[n2][2 * c + 1][3]);
            pf[n2] = __builtin_bit_cast(bf16x8, p);
        }
#pragma unroll
        for (int dt = 0; dt < 4; ++dt) {
            const bf16_t* vp = Vb + (size_t)(dt * 16 + fr) * 256 + 32 * c + fq * 4;
            const u32x2 lo = *(const u32x2*)vp, hi = *(const u32x2*)(vp + 16);
            u32x4 vv; vv.x = lo.x; vv.y = lo.y; vv.z = hi.x; vv.w = hi.y;
            const bf16x8 vf = __builtin_bit_cast(bf16x8, vv);
#pragma unroll
            for (int n2 = 0; n2 < 2; ++n2) o[n2][dt] = __builtin_amdgcn_mfma_f32_16x16x32_bf16(vf, pf[n2], o[n2][dt], 0, 0, 0);
        }
    }
#pragma unroll
    for (int n2 = 0; n2 < 2; ++n2)
#pragma unroll
        for (int dt = 0; dt < 4; ++dt) {
            const f32x4 r = o[n2][dt] * inv[n2];
            u32x2 w; w.x = cvt_pk_bf16(r[0], r[1]); w.y = cvt_pk_bf16(r[2], r[3]);
            *(u32x2*)(CAT + (size_t)(t0 + half * 32 + n2 * 16 + fr) * 1024 + 768 + h * 64 + dt * 16 + fq * 4) = w;
        }
}

__device__ __forceinline__ void conv_pass(const LAS unsigned char* hL, LAS unsigned char* cL, int hf, int tid, const float* dw, const float* db) {
    const int cp = tid % 192, tg = tid / 192;
    f32x2 w[31];
#pragma unroll
    for (int k = 0; k < 31; ++k) w[k] = *(const f32x2*)(dw + k * 384 + 2 * cp);
    const f32x2 bias = *(const f32x2*)(db + 2 * cp);
    f32x2 acc[16];
#pragma unroll
    for (int i = 0; i < 16; ++i) acc[i] = bias;
    const LAS unsigned* hp = (const LAS unsigned*)(hL + (hf * 32 + tg * 16) * HL_STRIDE) + cp;
#pragma unroll
    for (int r = 0; r < 46; ++r) {
        const unsigned v = hp[r * (HL_STRIDE / 4)];
        const f32x2 hv = (f32x2){bf_lo(v), bf_hi(v)};
#pragma unroll
        for (int i = 0; i < 16; ++i) { const int k = r - i; if (k >= 0 && k < 31) acc[i] = hv * w[k] + acc[i]; }
    }
#pragma unroll
    for (int i = 0; i < 16; ++i) *(LAS f32x2*)(cL + ((tg * 16 + i) * 384 + 2 * cp) * 4) = acc[i];
}

__device__ __forceinline__ void conv_ln_pass(const LAS unsigned char* cL, int trow0, int wid, int lane, const float* g, const float* b, bf16_t* CAT) {
    f32x2 gg[3], bb[3];
#pragma unroll
    for (int j = 0; j < 3; ++j) { gg[j] = *(const f32x2*)(g + 2 * lane + 128 * j); bb[j] = *(const f32x2*)(b + 2 * lane + 128 * j); }
#pragma unroll
    for (int i = 0; i < 4; ++i) {
        const int tl = 4 * wid + i;
        f32x2 v[3]; float s = 0.f;
#pragma unroll
        for (int j = 0; j < 3; ++j) { v[j] = *(const LAS f32x2*)(cL + (tl * 384 + 2 * lane + 128 * j) * 4); s += v[j].x + v[j].y; }
        const float mean = wave_sum(s) * (1.f / 384.f); float s2 = 0.f;
#pragma unroll
        for (int j = 0; j < 3; ++j) { v[j] = v[j] - mean; s2 += v[j].x * v[j].x + v[j].y * v[j].y; }
        const float rstd = 1.f / sqrtf(wave_sum(s2) * (1.f / 384.f) + LN_EPS);
#pragma unroll
        for (int j = 0; j < 3; ++j) {
            const f32x2 y = v[j] * rstd * gg[j] + bb[j];
            const float y0 = y.x * sigmoid_f(y.x), y1 = y.y * sigmoid_f(y.y);
            *(unsigned*)(CAT + (size_t)(trow0 + tl) * 1024 + 384 + 2 * lane + 128 * j) = cvt_pk_bf16(y0, y1);
        }
    }
}

__device__ __forceinline__ void mixer_unit(LAS unsigned char* lds, int unit, int tid, int wid, int lane, const bf16_t* Z, const bf16_t* KM, const bf16_t* VT, const bf16_t* PW,
                                           const float* pscale, const float* dw, const float* db, const float* cg_, const float* cb_, bf16_t* CAT) {
    const int fr = lane & 15, fq = lane >> 4;
    const int t0 = unit * 64;
    asm volatile("" : "+s"(Z), "+s"(KM), "+s"(VT), "+s"(PW), "+s"(pscale), "+s"(dw), "+s"(db), "+s"(cg_), "+s"(cb_), "+s"(CAT));
    int seg_lo, seg_hi, mb;
    if (t0 < TP) { mb = t0 >> 13; seg_lo = mb << 13; seg_hi = seg_lo + SEQP; } else { mb = 8; seg_lo = TP; seg_hi = T; }
    LAS unsigned char* uL = lds + UL_OFF; LAS unsigned char* hL = lds + HL_OFF; LAS unsigned char* cL = lds + CL_OFF;
    for (int i = tid; i < UL_ROWS * 48; i += NTHREADS) {
        const int ru = i / 48, ch = i - ru * 48, g = t0 - 8 + ru;
        u32x4 v = (u32x4){0u, 0u, 0u, 0u};
        if (g >= seg_lo && g < seg_hi) v = *(const u32x4*)(Z + (size_t)g * NIN + ch * 8);
        *(LAS u32x4*)(uL + ru * UL_STRIDE + ch * 16) = v;
    }
    for (int i = tid; i < HL_ROWS * 48; i += NTHREADS) {
        const int rh = i / 48, ch = i - rh * 48, g = t0 - 15 + rh;
        u32x4 o = (u32x4){0u, 0u, 0u, 0u};
        if (g >= seg_lo && g < seg_hi) {
            const u32x4 a = *(const u32x4*)(Z + (size_t)g * NIN + 384 + ch * 8), gt = *(const u32x4*)(Z + (size_t)g * NIN + 768 + ch * 8);
#pragma unroll
            for (int e = 0; e < 4; ++e) o[e] = cvt_pk_bf16(bf_lo(a[e]) * sigmoid_f(bf_lo(gt[e])), bf_hi(a[e]) * sigmoid_f(bf_hi(gt[e])));
        }
        *(LAS u32x4*)(hL + rh * HL_STRIDE + ch * 16) = o;
    }
    __syncthreads();
    {
        const int mt = wid & 3;
#define MIX_FENCE() do { asm volatile("" ::: "memory"); __builtin_amdgcn_sched_barrier(0); } while (0)
        if (wid < 4) { pool_job<0>(uL, mt, t0, seg_lo, seg_hi, PW, pscale, CAT, fr, fq); MIX_FENCE(); pool_job<3>(uL, mt, t0, seg_lo, seg_hi, PW, pscale, CAT, fr, fq); }
        else         { pool_job<1>(uL, mt, t0, seg_lo, seg_hi, PW, pscale, CAT, fr, fq); MIX_FENCE(); pool_job<2>(uL, mt, t0, seg_lo, seg_hi, PW, pscale, CAT, fr, fq); }
        MIX_FENCE();
        attn_job(t0, mb, wid, fr, fq, Z, KM, VT, CAT);
        MIX_FENCE();
    }
    __syncthreads();
#pragma unroll 1
    for (int hf = 0; hf < 2; ++hf) {
        if (wid < 6) conv_pass(hL, cL, hf, tid, dw, db);
        __syncthreads();
        conv_ln_pass(cL, t0 + hf * 32, wid, lane, cg_, cb_, CAT);
        __syncthreads();
    }
}

typedef const __attribute__((address_space(4))) Args* KArgs;
#define PHASE_VIEW() KArgs ap = (KArgs)__builtin_amdgcn_kernarg_segment_ptr(); asm volatile("" : "+s"(ap)); unsigned char* ws = ap->ws; float* out = ap->out; \
    const int tid = threadIdx.x, lane = tid & 63, wid = __builtin_amdgcn_readfirstlane(tid >> 6), G = gridDim.x, bx = blockIdx.x, gw = bx * NWAVES + wid, NGW = G * NWAVES; \
    (void)ws; (void)out; (void)lane; (void)gw; (void)NGW; (void)G; (void)bx
#define WSP(off) ((bf16_t*)(ws + (off)))

__global__ void __launch_bounds__(NTHREADS, 2) fwd_megakernel(Args args) {
    extern __shared__ __attribute__((aligned(16))) unsigned char lds_raw[];
    LAS unsigned char* lds = (LAS unsigned char*)lds_raw;
    cg::grid_group grid = cg::this_grid();
    const int lo = args.ph_lo, hi = args.ph_hi;
#ifndef PHMASK
#define PHMASK 0x7FF
#endif
#define IN(k) (((PHMASK >> (k)) & 1) && lo <= (k) && (k) < hi)
#define SEAM(k) do { if (IN(k) && IN((k) + 1)) grid.sync(); } while (0)

    if (IN(0)) {
        PHASE_VIEW();
        LAS float* scr = (LAS float*)(lds + wid * 16384);
        constexpr int I_GU = (D / 64) * (DFF / 32), I_DN = (DFF / 64) * (D / 32), I_IN = (D / 64) * (NIN / 32), I_KV = (D / 64) * (512 / 32), I_OUT = (D / 64) * (D / 32);
        constexpr int NITEMS = 4 * I_GU + 2 * I_DN + I_IN + I_KV + I_OUT;
        for (int it = gw; it < NITEMS; it += NGW) {
            int r = it;
            if (r < I_GU) { p0_transpose_item(ap->in[4], D, DFF, WSP(WS_WGU1), 1, scr, r, lane); continue; } r -= I_GU;
            if (r < I_GU) { p0_transpose_item(ap->in[5], D, DFF, WSP(WS_WGU1), 2, scr, r, lane); continue; } r -= I_GU;
            if (r < I_DN) { p0_transpose_item(ap->in[6], DFF, D, WSP(WS_WD1), 0, scr, r, lane); continue; } r -= I_DN;
            if (r < I_GU) { p0_transpose_item(ap->in[22], D, DFF, WSP(WS_WGU2), 1, scr, r, lane); continue; } r -= I_GU;
            if (r < I_GU) { p0_transpose_item(ap->in[23], D, DFF, WSP(WS_WGU2), 2, scr, r, lane); continue; } r -= I_GU;
            if (r < I_DN) { p0_transpose_item(ap->in[24], DFF, D, WSP(WS_WD2), 0, scr, r, lane); continue; } r -= I_DN;
            if (r < I_IN) { p0_transpose_item(ap->in[9], D, NIN, WSP(WS_WIN), 0, scr, r, lane); continue; } r -= I_IN;
            if (r < I_KV) { p0_transpose_item(ap->in[18], D, 512, WSP(WS_WKV), 0, scr, r, lane); continue; } r -= I_KV;
            p0_transpose_item(ap->in[19], D, D, WSP(WS_WOUT), 0, scr, r, lane);
        }
        for (int i = bx * NTHREADS + tid; i < (NINP - NIN) * D / 8; i += G * NTHREADS) ((u32x4*)(WSP(WS_WIN) + (size_t)NIN * D))[i] = (u32x4){0u, 0u, 0u, 0u};
        { const float* pw = ap->in[10]; bf16_t* PW = WSP(WS_PW);
          for (int i = bx * NTHREADS + tid; i < 4 * 96 * 96; i += G * NTHREADS) { const int g = i / 9216, r = i - g * 9216, d = r / 96, c = r - d * 96; PW[i] = (bf16_t)(cvt_pk_bf16(pw[g * 9216 + c * 96 + d], 0.f) & 0xffffu); } }
        { const float* xp = ap->in[0]; const float* xs = ap->in[1]; bf16_t* XB = WSP(WS_XB);
          for (size_t i = (size_t)bx * NTHREADS + tid; i < (size_t)T * D / 8; i += (size_t)G * NTHREADS) {
            const size_t e = i * 8; const float* src = (e < (size_t)TP * D) ? xp + e : xs + (e - (size_t)TP * D);
            const f32x4 a = *(const f32x4*)src, b = *(const f32x4*)(src + 4);
            u32x4 o; o.x = cvt_pk_bf16(a.x, a.y); o.y = cvt_pk_bf16(a.z, a.w); o.z = cvt_pk_bf16(b.x, b.y); o.w = cvt_pk_bf16(b.z, b.w);
            *(u32x4*)(XB + e) = o;
          } }
        { const float* mp = ap->in[2]; const float* ms = ap->in[3]; const float* mg = ap->in[16]; const float* mbb = ap->in[17]; bf16_t* MEMN = WSP(WS_MEMN);
          for (int m = gw; m < MEMROWS; m += NGW) {
            const float* src = (m < 8 * NMEM) ? mp + (size_t)m * D : ms + (size_t)(m - 8 * NMEM) * D;
            ln_row<true>(src, MEMN + (size_t)m * D, mg, mbb, lane);
          } }
        __syncthreads();
    }
    SEAM(0);

    if (IN(1)) {
        PHASE_VIEW();
        { pg8::Gemm g{WSP(WS_XB), WSP(WS_WGU1), T, NGU, D}; pg8::StaticOrder S; S.init(T, NGU, G, bx); pg8::EpiSwiGLU E{WSP(WS_H), DFF};
          pg8::gemm_phase<pg8::EpiSwiGLU, pg8::StaticOrder, true, true>(lds, g, S, E); }
        { pg8::Gemm g{WSP(WS_MEMN), WSP(WS_WKV), MEMROWS, 512, D}; pg8::StaticOrder S; S.init(MEMROWS, 512, G, (bx + G / 2) % G); pg8::EpiStore E{WSP(WS_K), WSP(WS_VT), 256, 512, 1};
          pg8::gemm_phase<pg8::EpiStore, pg8::StaticOrder, true, true>(lds, g, S, E); }
    }
    SEAM(1);
    if (IN(2)) {
        PHASE_VIEW();
        pg8::Gemm g{WSP(WS_H), WSP(WS_WD1), T, D, DFF}; pg8::StaticOrder S; S.init(T, D, G, bx); pg8::EpiRes E{out, ap->in[0], ap->in[1], nullptr, ALPHA, 0.5f};
        pg8::gemm_phase<pg8::EpiRes, pg8::StaticOrder, true, true>(lds, g, S, E);
    }
    SEAM(2);
    if (IN(3)) { PHASE_VIEW(); const float* g_ = ap->in[7]; const float* b_ = ap->in[8]; bf16_t* XB = WSP(WS_XB);
        for (int m = gw; m < T; m += NGW) ln_row<true>(out + (size_t)m * D, XB + (size_t)m * D, g_, b_, lane); }
    SEAM(3);
    if (IN(4)) {
        PHASE_VIEW();
        pg8::Gemm g{WSP(WS_XB), WSP(WS_WIN), T, NINP, D}; pg8::StaticOrder S; S.init(T, NINP, G, bx); pg8::EpiStore E{WSP(WS_Z), nullptr, NIN, NIN, 0};
        pg8::gemm_phase<pg8::EpiStore, pg8::StaticOrder, true, true>(lds, g, S, E);
    }
    SEAM(4);
    if (IN(5)) {
        PHASE_VIEW();
        const int nunits = T / 64, per = (nunits + G - 1) / G;
        const float* pscale = ap->in[11]; const float* dw = ap->in[12]; const float* db = ap->in[13]; const float* cg_ = ap->in[14]; const float* cb_ = ap->in[15];
        for (int u = bx * per; u < min(nunits, (bx + 1) * per); ++u)
            mixer_unit(lds, u, tid, wid, lane, WSP(WS_Z), WSP(WS_K), WSP(WS_VT), WSP(WS_PW), pscale, dw, db, cg_, cb_, WSP(WS_CAT));
    }
    SEAM(5);
    if (IN(6)) {
        PHASE_VIEW();
        pg8::Gemm g{WSP(WS_CAT), WSP(WS_WOUT), T, D, D}; pg8::StaticOrder S; S.init(T, D, G, bx); pg8::EpiRes E{out, nullptr, nullptr, WSP(WS_XB), ALPHA, 1.0f};
        pg8::gemm_phase<pg8::EpiRes, pg8::StaticOrder, true, true>(lds, g, S, E);
    }
    SEAM(6);
    if (IN(7)) { PHASE_VIEW(); const float* g_ = ap->in[20]; const float* b_ = ap->in[21]; bf16_t* XB = WSP(WS_XB);
        for (int m = gw; m < T; m += NGW) ln_row<true>(out + (size_t)m * D, XB + (size_t)m * D, g_, b_, lane); }
    SEAM(7);
    if (IN(8)) {
        PHASE_VIEW();
        pg8::Gemm g{WSP(WS_XB), WSP(WS_WGU2), T, NGU, D}; pg8::StaticOrder S; S.init(T, NGU, G, bx); pg8::EpiSwiGLU E{WSP(WS_H), DFF};
        pg8::gemm_phase<pg8::EpiSwiGLU, pg8::StaticOrder, true, true>(lds, g, S, E);
    }
    SEAM(8);
    if (IN(9)) {
        PHASE_VIEW();
        pg8::Gemm g{WSP(WS_H), WSP(WS_WD2), T, D, DFF}; pg8::StaticOrder S; S.init(T, D, G, bx); pg8::EpiRes E{out, nullptr, nullptr, WSP(WS_XB), ALPHA, 0.5f};
        pg8::gemm_phase<pg8::EpiRes, pg8::StaticOrder, true, true>(lds, g, S, E);
    }
    SEAM(9);
    if (IN(10)) { PHASE_VIEW(); const float* g_ = ap->in[25]; const float* b_ = ap->in[26];
        for (int m = gw; m < T; m += NGW) ln_row<false>(out + (size_t)m * D, out + (size_t)m * D, g_, b_, lane); }
#undef IN
#undef SEAM
}

#ifndef MK_MULTI
#define MK_MULTI 0
#endif
extern "C" void kernel_launch(void* const* d_in, const int* in_sizes, int n_in, void* d_out, int out_size, void* d_ws, size_t ws_size, hipStream_t stream) {
    static int grid = 0;
    if (grid == 0) {
        if (n_in != 27 || out_size != T * D || ws_size < WS_END) { fprintf(stderr, "kernel_launch: unexpected shapes (n_in %d out %d ws %zu)\n", n_in, out_size, ws_size); grid = -1; return; }
        int dev = 0, cus = 0, per_cu = 0;
        if (hipGetDevice(&dev) != hipSuccess || hipDeviceGetAttribute(&cus, hipDeviceAttributeMultiprocessorCount, dev) != hipSuccess) { grid = -1; return; }
        if (hipFuncSetAttribute((const void*)fwd_megakernel, hipFuncAttributeMaxDynamicSharedMemorySize, LDS_BYTES) != hipSuccess) { fprintf(stderr, "kernel_launch: hipFuncSetAttribute failed\n"); grid = -1; return; }
        if (hipOccupancyMaxActiveBlocksPerMultiprocessor(&per_cu, (const void*)fwd_megakernel, NTHREADS, LDS_BYTES) != hipSuccess || per_cu < 1) { fprintf(stderr, "kernel_launch: occupancy query says %d\n", per_cu); per_cu = 1; }
        (void)hipGetLastError();
        grid = cus * per_cu;
    }
    if (grid < 0) return;
    Args a{};
    for (int i = 0; i < 27; ++i) a.in[i] = (const float*)d_in[i];
    a.out = (float*)d_out; a.ws = (unsigned char*)d_ws;
#if MK_MULTI
    for (int p = 0; p < 11; ++p) { a.ph_lo = p; a.ph_hi = p + 1; hipLaunchKernelGGL(fwd_megakernel, dim3(grid), dim3(NTHREADS), LDS_BYTES, stream, a); }
#else
    a.ph_lo = 0; a.ph_hi = 11;
    void* kargs[] = {&a};
    hipError_t e = hipLaunchCooperativeKernel((const void*)fwd_megakernel, dim3(grid), dim3(NTHREADS), kargs, LDS_BYTES, stream);
    if (e != hipSuccess) fprintf(stderr, "cooperative launch failed: %s (grid %d)\n", hipGetErrorString(e), grid);
#endif
}
```
